# Optimizing an MI355X kernel written in HIP

```python
import math
import jax, jax.numpy as jnp
from jax import lax
import numpy as np

D_MODEL = 1024
BATCH = 8
SEQ = 2048
DEPTH = 1
DEC_BATCH = 128
DEC_SEQ = 4
PAST_LEN = 16384
PAGE_SIZE = 128

MIX_WIDTH = D_MODEL
A_WIDTH = MIX_WIDTH // 2
B_WIDTH = MIX_WIDTH - A_WIDTH
A_HEAD_DIM = 128
A_KEY_DIM = 128
A_HEADS = A_WIDTH // A_HEAD_DIM
A_QK = A_HEADS * A_KEY_DIM
CONV_WIDTH = 31
CHUNK = 64
EPS = 1e-6
IN_WIDTH = A_QK + A_QK + A_WIDTH + A_WIDTH + 2 * B_WIDTH + B_WIDTH

kernel_name = "hymba_hgrn2_conformer_conv_step"


def rmsnorm(x, g):
    xf = x.astype(jnp.float32)
    y = xf * lax.rsqrt(jnp.mean(xf * xf, axis=-1, keepdims=True) + EPS)
    return (y * g.astype(jnp.float32)).astype(x.dtype)


def layernorm(x, g, b):
    xf = x.astype(jnp.float32)
    mu = jnp.mean(xf, axis=-1, keepdims=True)
    var = jnp.mean(jnp.square(xf - mu), axis=-1, keepdims=True)
    y = (xf - mu) * lax.rsqrt(var + EPS)
    return (y * g.astype(jnp.float32) + b.astype(jnp.float32)).astype(x.dtype)


def hgrn2_chunked(q, k, v, logf, s0):
    n, t, h, dk = q.shape
    dv = v.shape[-1]
    c = math.gcd(t, CHUNK)
    nc = t // c

    def to_chunks(a):
        return a.astype(jnp.float32).reshape(n, nc, c, h, a.shape[-1]).transpose(1, 0, 3, 2, 4)

    qc, kc, vc, gc = to_chunks(q), to_chunks(k), to_chunks(v), to_chunks(logf)
    causal = jnp.tril(jnp.ones((c, c), dtype=bool))[:, :, None]

    def step(s, inp):
        qb, kb, vb, gb = inp
        g = jnp.cumsum(gb, axis=2)
        diff = g[:, :, :, None, :] - g[:, :, None, :, :]
        decay = jnp.exp(jnp.where(causal, diff, -jnp.inf))
        scores = jnp.einsum('nhtd,nhsd,nhtsd->nhts', qb, kb, decay)
        o = (jnp.einsum('nhts,nhsv->nhtv', scores, vb)
             + jnp.einsum('nhtd,nhdv->nhtv', qb * jnp.exp(g), s))
        g_last = g[:, :, -1:, :]
        s_new = (jnp.exp(g_last[:, :, 0, :])[..., None] * s
                 + jnp.einsum('nhsd,nhsv->nhdv', kb * jnp.exp(g_last - g), vb))
        return s_new, o

    s_fin, oc = lax.scan(step, s0.astype(jnp.float32), (qc, kc, vc, gc))
    o = oc.transpose(1, 0, 3, 2, 4).reshape(n, t, h, dv)
    return o, s_fin


def causal_dwconv(u, buf, w, b):
    full = jnp.concatenate([buf.astype(u.dtype), u], axis=1)
    y = lax.conv_general_dilated(full, w.astype(u.dtype)[:, None, :], (1,), 'VALID',
                                 dimension_numbers=('NWC', 'WIO', 'NWC'),
                                 feature_group_count=u.shape[-1])
    return y + b.astype(u.dtype), full[:, -(CONV_WIDTH - 1):]


def mixer_layer(x, s0, conv_buf, norm_g, w_in, lb, a_norm_g, b_glu, conv_w, conv_b, ln_g, ln_b, w_out):
    n, t, _ = x.shape
    h = rmsnorm(x, norm_g)
    proj = h @ w_in.astype(h.dtype)
    s1 = A_QK
    s2 = s1 + A_QK
    s3 = s2 + A_WIDTH
    s4 = s3 + A_WIDTH
    s5 = s4 + 2 * B_WIDTH
    q, fp, i, za, glu, zb = jnp.split(proj, [s1, s2, s3, s4, s5], axis=-1)
    q = jax.nn.silu(q)
    lbf = lb.astype(jnp.float32)
    f = lbf + (1.0 - lbf) * jax.nn.sigmoid(fp.astype(jnp.float32))
    k = 1.0 - f
    logf = jnp.log(f)
    heads = lambda a, d: a.reshape(n, t, A_HEADS, d)
    o_a, s_new = hgrn2_chunked(heads(q, A_KEY_DIM), heads(k, A_KEY_DIM),
                               heads(i, A_HEAD_DIM), heads(logf, A_KEY_DIM), s0)
    o_a = rmsnorm(o_a, a_norm_g).astype(x.dtype).reshape(n, t, A_WIDTH) * jax.nn.silu(za)
    glu = glu + b_glu.astype(glu.dtype)
    u = glu[..., :B_WIDTH] * jax.nn.sigmoid(glu[..., B_WIDTH:])
    cv, buf_new = causal_dwconv(u, conv_buf, conv_w, conv_b)
    o_b = jax.nn.silu(layernorm(cv, ln_g, ln_b)) * jax.nn.silu(zb)
    out = jnp.concatenate([o_a, o_b], axis=-1) @ w_out.astype(x.dtype)
    return x + out, s_new, buf_new


def setup_inputs(seed: int = 0) -> dict:
    key = jax.random.key(seed)
    ks = jax.random.split(key, 16)
    f32 = jnp.float32
    return {
        "x_prompt": jax.random.normal(ks[0], (BATCH, SEQ, D_MODEL), f32),
        "x_sample": jax.random.normal(ks[1], (DEC_BATCH, DEC_SEQ, D_MODEL), f32),
        "state_hgrn": 0.5 * jax.random.normal(ks[2], (DEPTH, DEC_BATCH, A_HEADS, A_KEY_DIM, A_HEAD_DIM), f32),
        "state_conv": 0.5 * jax.random.normal(ks[3], (DEPTH, DEC_BATCH, CONV_WIDTH - 1, B_WIDTH), f32),
        "norm_in_g": 1.0 + 0.05 * jax.random.normal(ks[4], (DEPTH, D_MODEL), f32),
        "w_in": jax.random.normal(ks[5], (DEPTH, D_MODEL, IN_WIDTH), f32) * D_MODEL ** -0.5,
        "lb_logits": 0.5 * jax.random.normal(ks[6], (DEPTH + 1, A_QK), f32),
        "hgrn_norm_g": 1.0 + 0.05 * jax.random.normal(ks[7], (DEPTH, A_HEAD_DIM), f32),
        "b_glu": 0.02 * jax.random.normal(ks[8], (DEPTH, 2 * B_WIDTH), f32),
        "conv_w": jax.random.normal(ks[9], (DEPTH, CONV_WIDTH, B_WIDTH), f32) * CONV_WIDTH ** -0.5,
        "conv_b": 0.02 * jax.random.normal(ks[10], (DEPTH, B_WIDTH), f32),
        "ln_g": 1.0 + 0.05 * jax.random.normal(ks[11], (DEPTH, B_WIDTH), f32),
        "ln_b": 0.02 * jax.random.normal(ks[12], (DEPTH, B_WIDTH), f32),
        "w_out": jax.random.normal(ks[13], (DEPTH, MIX_WIDTH, D_MODEL), f32) * MIX_WIDTH ** -0.5,
        "final_norm_g": 1.0 + 0.05 * jax.random.normal(ks[14], (D_MODEL,), f32),
    }


def reference(x_prompt, x_sample, state_hgrn, state_conv, norm_in_g, w_in, lb_logits, hgrn_norm_g,
              b_glu, conv_w, conv_b, ln_g, ln_b, w_out, final_norm_g):
    lb_all = jnp.cumsum(jax.nn.softmax(lb_logits.astype(jnp.float32), axis=0), axis=0)
    hp, hs = x_prompt, x_sample
    sp_list, cp_list, ss_list, cs_list = [], [], [], []
    for l in range(DEPTH):
        lw = (norm_in_g[l], w_in[l], lb_all[l], hgrn_norm_g[l], b_glu[l], conv_w[l], conv_b[l],
              ln_g[l], ln_b[l], w_out[l])
        s0p = jnp.zeros((hp.shape[0], A_HEADS, A_KEY_DIM, A_HEAD_DIM), jnp.float32)
        c0p = jnp.zeros((hp.shape[0], CONV_WIDTH - 1, B_WIDTH), hp.dtype)
        hp, sp, cp = mixer_layer(hp, s0p, c0p, *lw)
        hs, ss, cs = mixer_layer(hs, state_hgrn[l], state_conv[l], *lw)
        sp_list.append(sp)
        cp_list.append(cp)
        ss_list.append(ss)
        cs_list.append(cs)
    y_prompt = rmsnorm(hp, final_norm_g)
    y_sample = rmsnorm(hs, final_norm_g)
    new_state_hgrn_prompt = jnp.stack(sp_list)
    new_state_conv_prompt = jnp.stack(cp_list)
    new_state_hgrn_sample = jnp.stack(ss_list)
    new_state_conv_sample = jnp.stack(cs_list)
    return (y_prompt, y_sample, new_state_hgrn_prompt, new_state_conv_prompt, new_state_hgrn_sample, new_state_conv_sample)
```

```cpp
#include <hip/hip_runtime.h>
#include <hip/hip_cooperative_groups.h>
#include <cstdio>
namespace cg = cooperative_groups;
#define LAS __attribute__((address_space(3)))
namespace pg8 {
#define PG8_LAS __attribute__((address_space(3)))
typedef unsigned short bf16_t;
typedef short bf16x8 __attribute__((ext_vector_type(8)));
typedef float f32x4 __attribute__((ext_vector_type(4)));
typedef unsigned u32x4 __attribute__((ext_vector_type(4)));
constexpr int BM = 256, BK = 64, HALF = 128, HTB = HALF * BK * 2  , STAGE_BYTES = 8 * HTB, NXCD = 8, WGM = 8;

__host__ __device__ __forceinline__ int lds_byte(int r, int c) { const int st = (r >> 4) * 2 + (c >> 5), rr = r & 15, cc = c & 31, ob = rr * 64 + cc * 2; return st * 1024 + (ob ^ (((ob >> 9) & 1) << 5)); }
__host__ __device__ __forceinline__ void stage_rc(int b, int& R, int& C) { const int st = b / 1024, sb = b % 1024, swz = sb ^ (((sb >> 9) & 1) << 5); R = (st >> 1) * 16 + swz / 64; C = (st & 1) * 32 + (swz % 64) / 2; }
__host__ __device__ __forceinline__ int perm32(int rho) { const int n = rho >> 4, i = rho & 15; return 8 * (i >> 2) + 4 * n + (i & 3); }

struct Unit { int pm, pn; };
struct Gemm { const bf16_t* A; const bf16_t* Bt; int M, N, K; };

struct StaticOrder {
    int nM, nN, nwg, G, c;
    __host__ __device__ void init(int M, int N, int G_, int c_) { nM = M / BM; nN = N / BM; nwg = nM * nN; G = G_; c = c_; }
    __host__ __device__ bool next(int i, Unit& u) const {
        const long L = (long)i * G + c; if (L >= nwg) return false;
        int wgid = (int)L; { const int q = nwg / NXCD, r = nwg % NXCD, xcd = wgid % NXCD, off = wgid / NXCD; wgid = (xcd < r ? xcd * (q + 1) : r * (q + 1) + (xcd - r) * q) + off; }
        const int nig = WGM * nN, gid = wgid / nig, fm = gid * WGM, gsz = (nM - fm) < WGM ? (nM - fm) : WGM;
        u.pm = fm + ((wgid % nig) % gsz); u.pn = (wgid % nig) / gsz; return true;
    }
    __device__ __forceinline__ void a_ready(const Unit&) const {}
    __device__ __forceinline__ void done(const Unit&) const {}
};
typedef float f32x2c __attribute__((ext_vector_type(2)));
typedef __bf16 bf16x2c __attribute__((ext_vector_type(2)));
__device__ __forceinline__ unsigned cvt_pk_bf16(float lo, float hi) { f32x2c v = {lo, hi}; bf16x2c b = __builtin_convertvector(v, bf16x2c); return __builtin_bit_cast(unsigned, b); }
template <class Epi, class Sched, bool STAMP = false>
__device__ __forceinline__ void gemm_phase(PG8_LAS unsigned char* lds, const Gemm g, const Sched& S, const Epi& E, unsigned long long* stamps) {
    const int tid = threadIdx.x, wid = __builtin_amdgcn_readfirstlane(tid >> 6), lane = tid & 63, wr = wid >> 2, wc = wid & 3, fr = lane & 15, fq = lane >> 4;
    const int K = g.K, nt = K / BK;
    int ts_lo = 0, ts_hi = 0, nts = 0; const unsigned long long rt_entry = STAMP ? (unsigned long long)wall_clock64() : 0ull;
#define PG8_STAMP() do { if (STAMP && wid == 0 && nts < 64) { const unsigned long long _c = (unsigned long long)clock64(); \
        ts_lo = (lane == nts) ? (int)(unsigned)_c : ts_lo; ts_hi = (lane == nts) ? (int)(unsigned)(_c >> 32) : ts_hi; ++nts; } } while (0)
    PG8_STAMP();
    unsigned voffA[2], voffB[2];
#pragma unroll
    for (int i = 0; i < 2; ++i) { int R, C; stage_rc(tid * 16 + i * 8192, R, C); const int Rb = Epi::PERM ? ((R & ~31) + perm32(R & 31)) : R;
        voffA[i] = (unsigned)(R * K + C) * 2u; voffB[i] = (unsigned)(Rb * K + C) * 2u; }
    const size_t kstep = (size_t)(BK * 2);
    const size_t hstep = (size_t)HALF * K * 2;
    const size_t tstep = 2 * hstep;
    const unsigned ldsw = (unsigned)wid * 1024u;
    const int aoff = lds_byte(wr * 64 + fr, fq * 8), boff = lds_byte(wc * 32 + fr, fq * 8);
#define PG8_SA(b, h) (((b) * 2 + (h)) * HTB)
#define PG8_SB(b, h) ((4 + (b) * 2 + (h)) * HTB)
#define PG8_STAGE(bufoff, gbase, voff) do { _Pragma("unroll") for (int _i = 0; _i < 2; ++_i) \
        __builtin_amdgcn_global_load_lds((const unsigned*)((const char*)(gbase) + (voff)[_i]), (PG8_LAS unsigned*)(lds + (bufoff) + ldsw + _i * 8192), 16, 0, 0); } while (0)
#define PG8_LDA(dst, b, h) do { _Pragma("unroll") for (int m = 0; m < 4; ++m) _Pragma("unroll") for (int k = 0; k < 2; ++k) dst[m][k] = *(const PG8_LAS bf16x8*)(lds + PG8_SA(b, h) + aoff + m * 2048 + k * 1024); } while (0)
#define PG8_LDB(dst, b, h) do { _Pragma("unroll") for (int n = 0; n < 2; ++n) _Pragma("unroll") for (int k = 0; k < 2; ++k) dst[n][k] = *(const PG8_LAS bf16x8*)(lds + PG8_SB(b, h) + boff + n * 2048 + k * 1024); } while (0)
#define PG8_MMA(ai, bj, At, Bt) do { __builtin_amdgcn_s_setprio(1); _Pragma("unroll") for (int m = 0; m < 4; ++m) _Pragma("unroll") for (int n = 0; n < 2; ++n) _Pragma("unroll") for (int k = 0; k < 2; ++k) \
        acc[ai][bj][m][n] = __builtin_amdgcn_mfma_f32_16x16x32_bf16(Bt[n][k], At[m][k], acc[ai][bj][m][n], 0, 0, 0); __builtin_amdgcn_s_setprio(0); } while (0)
#define PG8_WAIT_V(n) asm volatile("s_waitcnt vmcnt(" #n ")" ::: "memory")
#define PG8_WAIT_L(n) asm volatile("s_waitcnt lgkmcnt(" #n ")" ::: "memory")
#define PG8_BAR __builtin_amdgcn_s_barrier()
#define PG8_SCHED __builtin_amdgcn_sched_barrier(0)
    Unit cur, nxt; int ui = 0;
    if (!S.next(0, cur)) return;
    f32x4 acc[2][2][4][2];
#pragma unroll
    for (int a = 0; a < 2; ++a)
#pragma unroll
        for (int b = 0; b < 2; ++b)
#pragma unroll
            for (int m = 0; m < 4; ++m)
#pragma unroll
                for (int n = 0; n < 2; ++n) acc[a][b][m][n] = (f32x4){0.f, 0.f, 0.f, 0.f};
    bf16x8 At[4][2], B0[2][2], B1[2][2];
    const char* cA = (const char*)g.A + (size_t)cur.pm * tstep; const char* cB = (const char*)g.Bt + (size_t)cur.pn * tstep;
    S.a_ready(cur);
    PG8_STAGE(PG8_SB(0, 0), cB, voffB); PG8_STAGE(PG8_SA(0, 0), cA, voffA); PG8_STAGE(PG8_SB(0, 1), cB + hstep, voffB); PG8_STAGE(PG8_SA(0, 1), cA + hstep, voffA);
    if (wr == 1) PG8_BAR;
    PG8_WAIT_V(4); PG8_BAR;
    PG8_STAGE(PG8_SB(1, 0), cB + kstep, voffB); PG8_STAGE(PG8_SA(1, 0), cA + kstep, voffA); PG8_STAGE(PG8_SB(1, 1), cB + hstep + kstep, voffB);
    PG8_WAIT_V(6); PG8_BAR;
    PG8_STAMP();
    for (;;) {
        const bool has_next = S.next(ui + 1, nxt);
        const char* nA = has_next ? (const char*)g.A + (size_t)nxt.pm * tstep : cA; const char* nB = has_next ? (const char*)g.Bt + (size_t)nxt.pn * tstep : cB;
        for (int t = 0; t < nt; t += 2) {
            const bool last = (t == nt - 2);
            const char* a1 = cA + (size_t)(t + 1) * kstep;
            const char* a2 = last ? nA : cA + (size_t)(t + 2) * kstep; const char* b2 = last ? nB : cB + (size_t)(t + 2) * kstep;
            const char* a3 = a2 + kstep; const char* b3 = b2 + kstep;
            if (last && has_next) S.a_ready(nxt);
            PG8_LDB(B0, 0, 0); PG8_SCHED; PG8_LDA(At, 0, 0); PG8_STAGE(PG8_SA(1, 1), a1 + hstep, voffA);
            PG8_WAIT_L(8); PG8_BAR; PG8_WAIT_L(0); PG8_MMA(0, 0, At, B0); PG8_BAR; PG8_SCHED;
            PG8_LDB(B1, 0, 1); PG8_STAGE(PG8_SB(0, 0), b2, voffB);
            PG8_BAR; PG8_WAIT_L(0); PG8_MMA(0, 1, At, B1); PG8_BAR;
            PG8_LDA(At, 0, 1); PG8_STAGE(PG8_SA(0, 0), a2, voffA);
            PG8_BAR; PG8_WAIT_L(0); PG8_MMA(1, 0, At, B0); PG8_BAR; PG8_SCHED;
            PG8_STAGE(PG8_SB(0, 1), b2 + hstep, voffB);
            PG8_WAIT_V(6); PG8_BAR; PG8_MMA(1, 1, At, B1); PG8_BAR;
            PG8_LDB(B0, 1, 0); PG8_SCHED; PG8_LDA(At, 1, 0); PG8_STAGE(PG8_SA(0, 1), a2 + hstep, voffA);
            PG8_WAIT_L(8); PG8_BAR; PG8_WAIT_L(0); PG8_MMA(0, 0, At, B0); PG8_BAR; PG8_SCHED;
            PG8_LDB(B1, 1, 1); PG8_STAGE(PG8_SB(1, 0), b3, voffB);
            PG8_BAR; PG8_WAIT_L(0); PG8_MMA(0, 1, At, B1); PG8_BAR;
            PG8_LDA(At, 1, 1); PG8_STAGE(PG8_SA(1, 0), a3, voffA);
            PG8_BAR; PG8_WAIT_L(0); PG8_MMA(1, 0, At, B0); PG8_BAR; PG8_SCHED;
            PG8_STAGE(PG8_SB(1, 1), b3 + hstep, voffB);
            PG8_WAIT_V(6); PG8_BAR; PG8_MMA(1, 1, At, B1); PG8_BAR;
        }
        PG8_STAMP();
        if constexpr (!Epi::AFTER_DRAIN) { E(acc, cur, wr, wc, fr, fq); S.done(cur); }
        PG8_STAMP();
        if (!has_next) break;
#pragma unroll
        for (int a = 0; a < 2; ++a)
#pragma unroll
            for (int b = 0; b < 2; ++b)
#pragma unroll
                for (int m = 0; m < 4; ++m)
#pragma unroll
                    for (int n = 0; n < 2; ++n) acc[a][b][m][n] = (f32x4){0.f, 0.f, 0.f, 0.f};
        cur = nxt; cA = nA; cB = nB; ++ui;
    }
    PG8_WAIT_V(0);
    if (wr == 0) PG8_BAR;
    PG8_BAR;
    if constexpr (Epi::AFTER_DRAIN) { E.fused(acc, cur, wr, wc, fr, fq, lds, wid, lane); S.done(cur); }
    PG8_STAMP();
    if (STAMP && wid == 0) { stamps[lane] = lane < nts ? (((unsigned long long)(unsigned)ts_hi << 32) | (unsigned)ts_lo) : 0ull;
        if (lane == 62) stamps[62] = rt_entry; if (lane == 63) stamps[63] = (unsigned long long)wall_clock64(); }
#undef PG8_STAMP
#undef PG8_SA
#undef PG8_SB
#undef PG8_STAGE
#undef PG8_LDA
#undef PG8_LDB
#undef PG8_MMA
#undef PG8_WAIT_V
#undef PG8_WAIT_L
#undef PG8_BAR
#undef PG8_SCHED
}
}
#define XB_TMO      128
#define XB_XCNT(j)  (256  + 64 * (j))
#define XB_XSUB(j)  (1280 + 64 * (j))
#define XB_XGEN(j)  (2304 + 64 * (j))
#define XB_TOP      3328
#define XB_TOPGEN   3392
#define XCD_BAR_WORDS 3456
#define XB_SPIN_CAP (1u << 18)
__device__ __forceinline__ unsigned xb_ld(unsigned* p)              { return __hip_atomic_load(p, __ATOMIC_RELAXED, __HIP_MEMORY_SCOPE_AGENT); }
__device__ __forceinline__ unsigned xb_add(unsigned* p, unsigned v) { return __hip_atomic_fetch_add(p, v, __ATOMIC_RELAXED, __HIP_MEMORY_SCOPE_AGENT); }
__device__ __forceinline__ unsigned xb_xcc_id() { return (unsigned)__builtin_amdgcn_s_getreg((3 << 11) | 20) & 0xFu; }
#define XB_SPIN(cond, bar) do { unsigned _sp = 0; while (cond) { __builtin_amdgcn_s_sleep(1); \
    if ((++_sp & 255u) == 0u) { if (xb_ld(&(bar)[XB_TMO])) break; if (_sp > XB_SPIN_CAP) { atomicAdd(&(bar)[XB_TMO], 1u); break; } } } } while (0)

struct XcdBarrier {
    unsigned* bar; unsigned x;
    volatile LAS unsigned* st;
};

__device__ __forceinline__ XcdBarrier xcd_barrier_post(unsigned* bar, volatile LAS unsigned* st) {
    XcdBarrier b; b.bar = bar; b.x = xb_xcc_id(); b.st = st;
    if (threadIdx.x == 0) (void)xb_add(&bar[XB_XCNT(b.x)], 1u);
    return b;
}
__device__ __forceinline__ void xcd_barrier_complete(unsigned* bar, unsigned x, unsigned& nloc, unsigned& nx) {
    const unsigned G = gridDim.x * gridDim.y * gridDim.z;
    unsigned sum, cnt, mine, sp = 0u;
    for (;;) {
        sum = 0u; cnt = 0u; mine = 0u;
#pragma unroll
        for (unsigned j = 0; j < 16; ++j) { const unsigned c = xb_ld(&bar[XB_XCNT(j)]); sum += c; cnt += (c > 0u) ? 1u : 0u; mine = (j == x) ? c : mine; }
        if (sum == G) break;
        __builtin_amdgcn_s_sleep(1);
        if ((++sp & 255u) == 0u) { if (xb_ld(&bar[XB_TMO])) break; if (sp > XB_SPIN_CAP) { atomicAdd(&bar[XB_TMO], 1u); break; } }
    }
    nloc = mine > 0u ? mine : 1u; nx = cnt > 0u ? cnt : 1u;
}

__device__ __forceinline__ void xcd_barrier(const XcdBarrier& b) {
    asm volatile("s_waitcnt vmcnt(0)" ::: "memory");
    __syncthreads();
    if (threadIdx.x == 0) {
        unsigned* bar = b.bar;
        __builtin_amdgcn_s_waitcnt(0);
        unsigned nloc = b.st[0], nx = b.st[1];
        if (nloc == 0u) { xcd_barrier_complete(bar, b.x, nloc, nx); b.st[0] = nloc; b.st[1] = nx; }
        const unsigned old = xb_add(&bar[XB_XSUB(b.x)], 1u);
        const unsigned gen = old / nloc;
        if (old + 1u == (gen + 1u) * nloc) {
            __builtin_amdgcn_fence(__ATOMIC_RELEASE, "agent");
            asm volatile("s_waitcnt vmcnt(0)" ::: "memory");
            const unsigned og = xb_add(&bar[XB_TOP], 1u);
            const unsigned tg = og / nx;
            if (og + 1u == (tg + 1u) * nx) xb_add(&bar[XB_TOPGEN], 1u);
            else XB_SPIN(xb_ld(&bar[XB_TOPGEN]) == tg, bar);
            __builtin_amdgcn_fence(__ATOMIC_ACQUIRE, "agent");
            xb_add(&bar[XB_XGEN(b.x)], 1u);
            asm volatile("s_waitcnt vmcnt(0)" ::: "memory");
        } else {
            XB_SPIN(xb_ld(&bar[XB_XGEN(b.x)]) == gen, bar);
            __builtin_amdgcn_fence(__ATOMIC_ACQUIRE, "agent");
            asm volatile("s_waitcnt vmcnt(0)" ::: "memory");
        }
    }
    __syncthreads();
}


using pg8::bf16_t; using pg8::bf16x8; using pg8::f32x4; using pg8::u32x4;
typedef unsigned u32x2 __attribute__((ext_vector_type(2)));


constexpr int MP = 16384, MS = 512, MT = MP + MS, DM = 1024, NIN = 3584;
constexpr int LDS_BYTES = 131072 + 16;
#ifndef PHASE_MASK
#define PHASE_MASK 0xFFFF
#endif

constexpr size_t SZ_ACT = (size_t)MT * 512 * 2;
constexpr size_t OFF_XB = 0;
constexpr size_t OFF_WINT = OFF_XB + (size_t)MT * 1024 * 2;
constexpr size_t OFF_WOUTT = OFF_WINT + (size_t)NIN * 1024 * 2;
constexpr size_t OFF_LB = OFF_WOUTT + (size_t)1024 * 1024 * 2;
constexpr size_t OFF_Q = OFF_LB + 2048;
constexpr size_t OFF_KK = OFF_Q + SZ_ACT;
constexpr size_t OFF_V = OFF_KK + SZ_ACT;
constexpr size_t OFF_ZA = OFF_V + SZ_ACT;
constexpr size_t OFF_U = OFF_ZA + SZ_ACT;
constexpr size_t OFF_ZB = OFF_U + SZ_ACT;
constexpr size_t OFF_LOGF = OFF_ZB + SZ_ACT;
constexpr size_t OFF_AC = OFF_LOGF + (size_t)MT * 512 * 4;
constexpr size_t OFF_UC = OFF_AC + (size_t)1024 * 128 * 4;
constexpr size_t OFF_SC = OFF_UC + (size_t)1024 * 16384 * 2;
constexpr size_t OFF_BAR = OFF_SC + (size_t)1024 * 16384 * 2;
constexpr size_t WS_END = OFF_BAR + (size_t)XCD_BAR_WORDS * 4;
constexpr size_t O_YP = 0, O_YS = (size_t)MP * 1024, O_HP = (size_t)MT * 1024, O_CP = O_HP + 8 * 4 * 16384, O_HS = O_CP + 8 * 30 * 512, O_CS = O_HS + (size_t)128 * 4 * 16384;
constexpr size_t OUTB_UC = 0, OUTB_SC = (size_t)1024 * 16384 * 2;

struct Params {
    const float *x_prompt, *x_sample, *state_hgrn, *state_conv, *norm_in_g, *w_in, *lb_logits, *hgrn_norm_g, *b_glu, *conv_w, *conv_b, *ln_g, *ln_b, *w_out, *final_norm_g;
    float* out; unsigned char* ws;
};

__device__ __forceinline__ float bf2f(bf16_t h) { return __uint_as_float((unsigned)h << 16); }
__device__ __forceinline__ float bflo(unsigned w) { return __uint_as_float(w << 16); }
__device__ __forceinline__ float bfhi(unsigned w) { return __uint_as_float(w & 0xffff0000u); }
__device__ __forceinline__ unsigned pk2(float lo, float hi) { return pg8::cvt_pk_bf16(lo, hi); }
__device__ __forceinline__ bf16_t f2bf(float f) { return (bf16_t)(pk2(f, 0.f) & 0xffffu); }
__device__ __forceinline__ float wave_sum(float v) {
#pragma unroll
    for (int o = 1; o < 64; o <<= 1) v += __shfl_xor(v, o);
    return v;
}
__device__ __forceinline__ float rcpf_(float x) { return __builtin_amdgcn_rcpf(x); }
__device__ __forceinline__ float sigm(float x) { return rcpf_(1.f + __expf(-x)); }
__device__ __forceinline__ float silu(float x) { return x * rcpf_(1.f + __expf(-x)); }
#define LDS_WAIT() asm volatile("s_waitcnt lgkmcnt(0)" ::: "memory")

__device__ __forceinline__ int mapcol(int n) {
    if (n < 2048 || n >= 3072) return n;
    const int r = n - 2048, j = r >> 8, rr = r & 255, half = rr >> 7, o = rr & 127;
    return 2048 + half * 512 + 128 * j + o;
}
__device__ __forceinline__ void transpose_item(const float* W, int N, bf16_t* WT, int item, LAS float* scr, int lane, const float* gs, bool remap) {
    const int nblk = N / 32, kb = item / nblk, nb = item % nblk, k0 = 64 * kb, n0 = 32 * nb;
    const int sn0 = remap ? mapcol(n0) : n0;
#pragma unroll 8
    for (int i = 0; i < 32; ++i) { const int kk = 2 * i + (lane >> 5); float w = W[(size_t)(k0 + kk) * N + sn0 + (lane & 31)]; if (gs) w *= gs[k0 + kk]; scr[kk * 33 + (lane & 31)] = w; }
    LDS_WAIT();
    const int c = lane & 7;
#pragma unroll
    for (int j = 0; j < 4; ++j) { const int n = (lane >> 3) + 8 * j; const LAS float* s = scr + (8 * c) * 33 + n;
        u32x4 o; o.x = pk2(s[0 * 33], s[1 * 33]); o.y = pk2(s[2 * 33], s[3 * 33]); o.z = pk2(s[4 * 33], s[5 * 33]); o.w = pk2(s[6 * 33], s[7 * 33]);
        *(u32x4*)(WT + (size_t)(n0 + n) * 1024 + k0 + 8 * c) = o; }
    LDS_WAIT();
}
__device__ __forceinline__ void phase0(const Params& p, LAS unsigned char* lds, int G) {
    const int tid = threadIdx.x, lane = tid & 63, wave = tid >> 6;
    const int gw = blockIdx.x * 8 + wave, NGW = G * 8;
    bf16_t* XB = (bf16_t*)(p.ws + OFF_XB);
    for (int row = gw; row < MT; row += NGW) {
        const float* src = row < MP ? p.x_prompt + (size_t)row * DM : p.x_sample + (size_t)(row - MP) * DM;
        const f32x4* xr = (const f32x4*)src + lane;
        f32x4 v[4]; float s = 0.f;
#pragma unroll
        for (int j = 0; j < 4; ++j) { v[j] = xr[64 * j]; s += (v[j].x * v[j].x + v[j].y * v[j].y) + (v[j].z * v[j].z + v[j].w * v[j].w); }
        const float rs = rsqrtf(wave_sum(s) * (1.f / 1024.f) + 1e-6f);
        u32x2* o = (u32x2*)(XB + (size_t)row * DM) + lane;
#pragma unroll
        for (int j = 0; j < 4; ++j) { u32x2 w; w.x = pk2(v[j].x * rs, v[j].y * rs); w.y = pk2(v[j].z * rs, v[j].w * rs); o[64 * j] = w; }
    }
    LAS float* scr = (LAS float*)(lds + wave * 8448);
    constexpr int I_IN = 16 * (NIN / 32), I_OUT = 16 * 32;
    bf16_t* WINT = (bf16_t*)(p.ws + OFF_WINT); bf16_t* WOUTT = (bf16_t*)(p.ws + OFF_WOUTT);
    for (int it = gw; it < I_IN + I_OUT; it += NGW) {
        if (it < I_IN) transpose_item(p.w_in, NIN, WINT, it, scr, lane, p.norm_in_g, true);
        else transpose_item(p.w_out, 1024, WOUTT, it - I_IN, scr, lane, nullptr, false);
    }
    if (blockIdx.x == 0) { const float l0 = p.lb_logits[tid], l1 = p.lb_logits[512 + tid]; ((float*)(p.ws + OFF_LB))[tid] = 1.f / (1.f + __expf(l1 - l0)); }
}

struct Epi1 {
    static constexpr bool PERM = true, AFTER_DRAIN = false;
    bf16_t *Q, *KK, *V, *ZA, *U, *ZB; float* LOGF; const float* LB; const float* bglu;
    __device__ __forceinline__ void operator()(const f32x4 (&acc)[2][2][4][2], const pg8::Unit& u, int wr, int wc, int fr, int fq) const {
        const int row0 = u.pm * 256 + wr * 64 + fr, pn = u.pn, cw = wc * 32 + 8 * fq;
        if (pn >= 8 && pn < 12) {
            const int uc = (pn - 8) * 128 + cw;
            const f32x4 ba0 = *(const f32x4*)(bglu + uc), ba1 = *(const f32x4*)(bglu + uc + 4), bg0 = *(const f32x4*)(bglu + 512 + uc), bg1 = *(const f32x4*)(bglu + 512 + uc + 4);
#pragma unroll
            for (int ai = 0; ai < 2; ++ai)
#pragma unroll
                for (int m = 0; m < 4; ++m) {
                    const f32x4 a0 = acc[ai][0][m][0] + ba0, a1 = acc[ai][0][m][1] + ba1, g0 = acc[ai][1][m][0] + bg0, g1 = acc[ai][1][m][1] + bg1;
                    u32x4 w; w.x = pk2(a0[0] * sigm(g0[0]), a0[1] * sigm(g0[1])); w.y = pk2(a0[2] * sigm(g0[2]), a0[3] * sigm(g0[3]));
                    w.z = pk2(a1[0] * sigm(g1[0]), a1[1] * sigm(g1[1])); w.w = pk2(a1[2] * sigm(g1[2]), a1[3] * sigm(g1[3]));
                    *(u32x4*)(U + (size_t)(row0 + ai * 128 + m * 16) * 512 + uc) = w;
                }
        } else if (pn == 2 || pn == 3) {
#pragma unroll
            for (int bj = 0; bj < 2; ++bj) {
                const int cf = (pn - 2) * 256 + bj * 128 + cw;
                const f32x4 l0 = *(const f32x4*)(LB + cf), l1 = *(const f32x4*)(LB + cf + 4);
#pragma unroll
                for (int ai = 0; ai < 2; ++ai)
#pragma unroll
                    for (int m = 0; m < 4; ++m) {
                        const size_t o = (size_t)(row0 + ai * 128 + m * 16) * 512 + cf;
                        f32x4 lf0, lf1, k0, k1;
#pragma unroll
                        for (int e = 0; e < 4; ++e) {
                            { const float z = acc[ai][bj][m][0][e], ex = __expf(-z), s = rcpf_(1.f + ex), lb = l0[e]; lf0[e] = __logf(lb + (1.f - lb) * s); k0[e] = (1.f - lb) * ex * s; }
                            { const float z = acc[ai][bj][m][1][e], ex = __expf(-z), s = rcpf_(1.f + ex), lb = l1[e]; lf1[e] = __logf(lb + (1.f - lb) * s); k1[e] = (1.f - lb) * ex * s; }
                        }
                        *(f32x4*)(LOGF + o) = lf0; *(f32x4*)(LOGF + o + 4) = lf1;
                        u32x4 w; w.x = pk2(k0[0], k0[1]); w.y = pk2(k0[2], k0[3]); w.z = pk2(k1[0], k1[1]); w.w = pk2(k1[2], k1[3]);
                        *(u32x4*)(KK + o) = w;
                    }
            }
        } else {
            bf16_t* dst; int cb; bool act = true;
            if (pn < 2) { dst = Q; cb = pn * 256; } else if (pn < 6) { dst = V; cb = (pn - 4) * 256; act = false; } else if (pn < 8) { dst = ZA; cb = (pn - 6) * 256; } else { dst = ZB; cb = (pn - 12) * 256; }
#pragma unroll
            for (int bj = 0; bj < 2; ++bj) {
                const int c = cb + bj * 128 + cw;
#pragma unroll
                for (int ai = 0; ai < 2; ++ai)
#pragma unroll
                    for (int m = 0; m < 4; ++m) {
                        f32x4 v0 = acc[ai][bj][m][0], v1 = acc[ai][bj][m][1];
                        if (act) {
#pragma unroll
                            for (int e = 0; e < 4; ++e) { v0[e] = silu(v0[e]); v1[e] = silu(v1[e]); }
                        }
                        u32x4 w; w.x = pk2(v0[0], v0[1]); w.y = pk2(v0[2], v0[3]); w.z = pk2(v1[0], v1[1]); w.w = pk2(v1[2], v1[3]);
                        *(u32x4*)(dst + (size_t)(row0 + ai * 128 + m * 16) * 512 + c) = w;
                    }
            }
        }
    }
};
struct Epi2 {
    static constexpr bool PERM = false, AFTER_DRAIN = false;
    const float *xp, *xs; float* out;
    __device__ __forceinline__ void operator()(const f32x4 (&acc)[2][2][4][2], const pg8::Unit& u, int wr, int wc, int fr, int fq) const {
        const int row0 = u.pm * 256 + wr * 64 + fr, col0 = u.pn * 256 + wc * 32 + 4 * fq;
#pragma unroll
        for (int ai = 0; ai < 2; ++ai)
#pragma unroll
            for (int m = 0; m < 4; ++m) {
                const int row = row0 + ai * 128 + m * 16;
                const float* xr = row < MP ? xp + (size_t)row * 1024 : xs + (size_t)(row - MP) * 1024;
                float* o = out + (size_t)row * 1024;
#pragma unroll
                for (int bj = 0; bj < 2; ++bj)
#pragma unroll
                    for (int n = 0; n < 2; ++n) { const int c = col0 + bj * 128 + n * 16; *(f32x4*)(o + c) = *(const f32x4*)(xr + c) + acc[ai][bj][m][n]; }
            }
    }
};

#define MFMA16(a, b, c) __builtin_amdgcn_mfma_f32_16x16x32_bf16(a, b, c, 0, 0, 0)

__device__ __forceinline__ void phase_chunkU(const Params& p, LAS unsigned char* lds, int G) {
    const int tid = threadIdx.x, lane = tid & 63, wave = tid >> 6, d = tid & 127, sq = tid >> 7, fr = lane & 15, fq = lane >> 4;
    LAS bf16_t* kT = (LAS bf16_t*)lds;
    LAS bf16_t* vT = (LAS bf16_t*)(lds + 18432);
    LAS float* seg = (LAS float*)(lds + 36864);
    const float* LOGF = (const float*)(p.ws + OFF_LOGF); const bf16_t* KK = (const bf16_t*)(p.ws + OFF_KK); const bf16_t* V = (const bf16_t*)(p.ws + OFF_V);
    float* AC = (float*)(p.ws + OFF_AC); bf16_t* UC = (bf16_t*)(p.ws + OFF_UC);
    for (int unit = blockIdx.x; unit < 1024; unit += G) {
        const int nh = unit >> 5, c = unit & 31, n = nh >> 2, h = nh & 3;
        const size_t row0 = (size_t)n * 2048 + c * 64;
        const float* lf = LOGF + (row0 + 16 * sq) * 512 + h * 128 + d;
        float g[16]; float run = 0.f;
#pragma unroll
        for (int i = 0; i < 16; ++i) { run += lf[(size_t)i * 512]; g[i] = run; }
        seg[sq * 128 + d] = run;
#pragma unroll
        for (int i = 0; i < 2; ++i) { const int id = tid + 512 * i, s = id >> 4, j = id & 15; const u32x4 w = *(const u32x4*)(V + (row0 + s) * 512 + h * 128 + 8 * j);
#pragma unroll
            for (int e = 0; e < 8; ++e) vT[(8 * j + e) * 72 + s] = (bf16_t)(w[e >> 1] >> (16 * (e & 1))); }
        __syncthreads();
        float off = 0.f, tot = 0.f;
#pragma unroll
        for (int q = 0; q < 4; ++q) { const float sv = seg[q * 128 + d]; tot += sv; if (q < sq) off += sv; }
        const bf16_t* kp = KK + (row0 + 16 * sq) * 512 + h * 128 + d;
        unsigned pk[8];
#pragma unroll
        for (int i = 0; i < 8; ++i) { const float k0 = bf2f(kp[(size_t)(2 * i) * 512]) * __expf(tot - (off + g[2 * i])), k1 = bf2f(kp[(size_t)(2 * i + 1) * 512]) * __expf(tot - (off + g[2 * i + 1])); pk[i] = pk2(k0, k1); }
        { u32x4 w0, w1; w0.x = pk[0]; w0.y = pk[1]; w0.z = pk[2]; w0.w = pk[3]; w1.x = pk[4]; w1.y = pk[5]; w1.z = pk[6]; w1.w = pk[7];
          *(LAS u32x4*)(kT + d * 72 + 16 * sq) = w0; *(LAS u32x4*)(kT + d * 72 + 16 * sq + 8) = w1; }
        if (sq == 0) AC[unit * 128 + d] = __expf(tot);
        __syncthreads();
        const bf16x8 a0 = *(const LAS bf16x8*)(kT + (wave * 16 + fr) * 72 + fq * 8), a1 = *(const LAS bf16x8*)(kT + (wave * 16 + fr) * 72 + 32 + fq * 8);
#pragma unroll
        for (int vb = 0; vb < 8; ++vb) {
            const bf16x8 b0 = *(const LAS bf16x8*)(vT + (vb * 16 + fr) * 72 + fq * 8), b1 = *(const LAS bf16x8*)(vT + (vb * 16 + fr) * 72 + 32 + fq * 8);
            f32x4 acc = {0.f, 0.f, 0.f, 0.f};
            acc = MFMA16(a0, b0, acc); acc = MFMA16(a1, b1, acc);
            u32x2 w; w.x = pk2(acc[0], acc[1]); w.y = pk2(acc[2], acc[3]);
            *(u32x2*)(UC + (size_t)unit * 16384 + (vb * 16 + fr) * 128 + wave * 16 + fq * 4) = w;
        }
        __syncthreads();
    }
}

__device__ __forceinline__ void phase_conv(const Params& p, LAS unsigned char* lds, int G) {
    const int tid = threadIdx.x, lane = tid & 63, wave = tid >> 6, c = tid;
    LAS bf16_t* UL = (LAS bf16_t*)lds;
    LAS float* red = (LAS float*)(lds + 96256);
    const bf16_t* U = (const bf16_t*)(p.ws + OFF_U); const bf16_t* ZB = (const bf16_t*)(p.ws + OFF_ZB); bf16_t* OAB = (bf16_t*)(p.ws + OFF_XB);
    float w[31];
#pragma unroll
    for (int j = 0; j < 31; ++j) w[j] = p.conv_w[j * 512 + c];
    const float cb = p.conv_b[c], lg = p.ln_g[c], lbb = p.ln_b[c];
    for (int unit = blockIdx.x; unit < 384; unit += G) {
        const bool samp = unit >= 256;
        const int n = samp ? unit - 256 : unit >> 5, t0 = samp ? 0 : (unit & 31) * 64, nrows = samp ? 34 : 94;
        const size_t rowbase = samp ? (size_t)MP + n * 4 : (size_t)n * 2048 + t0;
        for (int r = wave; r < nrows; r += 8) {
            u32x4 val = {0u, 0u, 0u, 0u};
            if (!samp) { const int t = t0 - 30 + r; if (t >= 0) val = *(const u32x4*)(U + ((size_t)n * 2048 + t) * 512 + lane * 8); }
            else if (r < 30) { const float* s = p.state_conv + ((size_t)n * 30 + r) * 512 + lane * 8; const f32x4 a = *(const f32x4*)s, b = *(const f32x4*)(s + 4);
                val.x = pk2(a.x, a.y); val.y = pk2(a.z, a.w); val.z = pk2(b.x, b.y); val.w = pk2(b.z, b.w); }
            else val = *(const u32x4*)(U + (rowbase + (r - 30)) * 512 + lane * 8);
            *(LAS u32x4*)(UL + r * 512 + lane * 8) = val;
        }
        __syncthreads();
        const int ng = samp ? 1 : 8;
        for (int tg = 0; tg < ng; ++tg) {
            float acc[8];
#pragma unroll
            for (int oo = 0; oo < 8; ++oo) acc[oo] = cb;
#pragma unroll
            for (int j = 0; j < 38; ++j) {
                const float uv = bf2f(UL[(8 * tg + j) * 512 + c]);
#pragma unroll
                for (int oo = 0; oo < 8; ++oo) if (j - oo >= 0 && j - oo <= 30) acc[oo] += w[j - oo] * uv;
            }
            float mine = 0.f;
#pragma unroll
            for (int oo = 0; oo < 8; ++oo) { const float s1 = wave_sum(acc[oo]), s2 = wave_sum(acc[oo] * acc[oo]); mine = (lane == oo) ? s1 : mine; mine = (lane == 8 + oo) ? s2 : mine; }
            if (lane < 16) red[wave * 16 + lane] = mine;
            __syncthreads();
            f32x4 t1[2] = {{0.f, 0.f, 0.f, 0.f}, {0.f, 0.f, 0.f, 0.f}}, t2[2] = {{0.f, 0.f, 0.f, 0.f}, {0.f, 0.f, 0.f, 0.f}};
#pragma unroll
            for (int wv = 0; wv < 8; ++wv) { t1[0] += *(const LAS f32x4*)(red + wv * 16); t1[1] += *(const LAS f32x4*)(red + wv * 16 + 4); t2[0] += *(const LAS f32x4*)(red + wv * 16 + 8); t2[1] += *(const LAS f32x4*)(red + wv * 16 + 12); }
#pragma unroll
            for (int oo = 0; oo < 8; ++oo) {
                const float mu = t1[oo >> 2][oo & 3] * (1.f / 512.f), var = t2[oo >> 2][oo & 3] * (1.f / 512.f) - mu * mu, rstd = rsqrtf(var + 1e-6f);
                const float y = (acc[oo] - mu) * rstd * lg + lbb;
                if (!samp || oo < 4) { const size_t row = rowbase + 8 * tg + oo; OAB[row * 1024 + 512 + c] = f2bf(silu(y) * bf2f(ZB[row * 512 + c])); }
            }
            __syncthreads();
        }
        if (!samp && (unit & 31) == 31) {
            float* o = p.out + O_CP + (size_t)n * 30 * 512;
            for (int r = wave; r < 30; r += 8) { const u32x4 v = *(const LAS u32x4*)(UL + (64 + r) * 512 + lane * 8);
                f32x4 a, b; a.x = bflo(v.x); a.y = bfhi(v.x); a.z = bflo(v.y); a.w = bfhi(v.y); b.x = bflo(v.z); b.y = bfhi(v.z); b.z = bflo(v.w); b.w = bfhi(v.w);
                *(f32x4*)(o + r * 512 + lane * 8) = a; *(f32x4*)(o + r * 512 + lane * 8 + 4) = b; }
        }
        if (samp) {
            float* o = p.out + O_CS + (size_t)n * 30 * 512;
            for (int r = wave; r < 30; r += 8) {
                f32x4 a, b;
                if (r < 26) { const float* s = p.state_conv + ((size_t)n * 30 + r + 4) * 512 + lane * 8; a = *(const f32x4*)s; b = *(const f32x4*)(s + 4); }
                else { const u32x4 v = *(const LAS u32x4*)(UL + (r + 4) * 512 + lane * 8);
                    a.x = bflo(v.x); a.y = bfhi(v.x); a.z = bflo(v.y); a.w = bfhi(v.y); b.x = bflo(v.z); b.y = bfhi(v.z); b.z = bflo(v.w); b.w = bfhi(v.w); }
                *(f32x4*)(o + r * 512 + lane * 8) = a; *(f32x4*)(o + r * 512 + lane * 8 + 4) = b;
            }
        }
        __syncthreads();
    }
}

__device__ __forceinline__ void phase_sample_hgrn(const Params& p, LAS unsigned char* lds, int G) {
    const int tid = threadIdx.x, lane = tid & 63, wave = tid >> 6, vq = tid & 31, dg = tid >> 5;
    LAS float* par = (LAS float*)lds;
    LAS float* PO = (LAS float*)(lds + 8192);
    LAS float* red = (LAS float*)(lds + 8192 + 32768);
    const float* LOGF = (const float*)(p.ws + OFF_LOGF); const bf16_t* KK = (const bf16_t*)(p.ws + OFF_KK); const bf16_t* V = (const bf16_t*)(p.ws + OFF_V);
    const bf16_t* Q = (const bf16_t*)(p.ws + OFF_Q); const bf16_t* ZA = (const bf16_t*)(p.ws + OFF_ZA); bf16_t* OAB = (bf16_t*)(p.ws + OFF_XB);
    for (int unit = blockIdx.x; unit < 512; unit += G) {
        const int n = unit >> 2, h = unit & 3;
        { const int t = tid >> 7, d = tid & 127; const size_t idx = ((size_t)MP + n * 4 + t) * 512 + h * 128 + d;
          par[t * 128 + d] = __expf(LOGF[idx]); par[512 + t * 128 + d] = bf2f(KK[idx]); par[1024 + t * 128 + d] = bf2f(Q[idx]); par[1536 + t * 128 + d] = bf2f(V[idx]); }
        const float* Sin = p.state_hgrn + (size_t)unit * 16384; float* Sout = p.out + O_HS + (size_t)unit * 16384;
        f32x4 S[8];
#pragma unroll
        for (int i = 0; i < 8; ++i) S[i] = *(const f32x4*)(Sin + (dg + 16 * i) * 128 + 4 * vq);
        __syncthreads();
#pragma unroll
        for (int t = 0; t < 4; ++t) {
            const f32x4 vv = *(const LAS f32x4*)(par + 1536 + t * 128 + 4 * vq); f32x4 po = {0.f, 0.f, 0.f, 0.f};
#pragma unroll
            for (int i = 0; i < 8; ++i) { const int d = dg + 16 * i; const float fd = par[t * 128 + d], kd = par[512 + t * 128 + d], qd = par[1024 + t * 128 + d]; S[i] = fd * S[i] + kd * vv; po += S[i] * qd; }
            *(LAS f32x4*)(PO + (dg * 4 + t) * 128 + 4 * vq) = po;
        }
#pragma unroll
        for (int i = 0; i < 8; ++i) *(f32x4*)(Sout + (dg + 16 * i) * 128 + 4 * vq) = S[i];
        __syncthreads();
        { const int t = tid >> 7, v = tid & 127; float o = 0.f;
#pragma unroll
          for (int g2 = 0; g2 < 16; ++g2) o += PO[(g2 * 4 + t) * 128 + v];
          const float ss = wave_sum(o * o); if (lane == 0) red[wave] = ss;
          __syncthreads();
          const float tot = red[2 * t] + red[2 * t + 1], r = rsqrtf(tot * (1.f / 128.f) + 1e-6f);
          const size_t row = (size_t)MP + n * 4 + t;
          OAB[row * 1024 + h * 128 + v] = f2bf(o * r * p.hgrn_norm_g[v] * bf2f(ZA[row * 512 + h * 128 + v])); }
        __syncthreads();
    }
}

__device__ __forceinline__ void phase_scan(const Params& p, LAS unsigned char* lds, int G) {
    LAS float* tr = (LAS float*)lds;
    const float* AC = (const float*)(p.ws + OFF_AC); const bf16_t* UC = (const bf16_t*)(p.ws + OFF_UC); bf16_t* SC = (bf16_t*)(p.ws + OFF_SC);
    for (int blk = blockIdx.x; blk < 256; blk += G) {
        const int nh = blk >> 3, sub = blk & 7, v = (sub >> 1) * 32 + (threadIdx.x >> 4), d = (sub & 1) * 64 + (threadIdx.x & 15) * 4, off = v * 128 + d;
        f32x4 S = {0.f, 0.f, 0.f, 0.f};
#pragma unroll 8
        for (int c = 0; c < 32; ++c) {
            const size_t unit = (size_t)nh * 32 + c;
            u32x2 w; w.x = pk2(S.x, S.y); w.y = pk2(S.z, S.w);
            *(u32x2*)(SC + unit * 16384 + off) = w;
            const f32x4 a = *(const f32x4*)(AC + unit * 128 + d); const u32x2 uu = *(const u32x2*)(UC + unit * 16384 + off);
#ifdef DIAG_SKIP31
            if (c == 31) break;
#endif
#ifdef DIAG_UONLY
            if (c == DIAG_UONLY) { S.x = bflo(uu.x); S.y = bfhi(uu.x); S.z = bflo(uu.y); S.w = bfhi(uu.y); break; } else continue;
#endif
#ifdef DIAG_AONLY
            if (c == DIAG_AONLY) { S = a; break; } else continue;
#endif
            S.x = a.x * S.x + bflo(uu.x); S.y = a.y * S.y + bfhi(uu.x); S.z = a.z * S.z + bflo(uu.y); S.w = a.w * S.w + bfhi(uu.y);
        }
        {
            const int dl = (threadIdx.x & 15) * 4, vl = threadIdx.x >> 4;
            tr[(dl + 0) * 33 + vl] = S.x; tr[(dl + 1) * 33 + vl] = S.y; tr[(dl + 2) * 33 + vl] = S.z; tr[(dl + 3) * 33 + vl] = S.w;
            __syncthreads();
            const int dr = threadIdx.x >> 3, v4 = (threadIdx.x & 7) * 4;
            f32x4 ov; ov.x = tr[dr * 33 + v4]; ov.y = tr[dr * 33 + v4 + 1]; ov.z = tr[dr * 33 + v4 + 2]; ov.w = tr[dr * 33 + v4 + 3];
#ifdef DIAG_ALT_HP
            *(f32x4*)(p.out + O_HS + (size_t)nh * 16384 + ((sub & 1) * 64 + dr) * 128 + (sub >> 1) * 32 + v4) = ov;
#endif
            *(f32x4*)(p.out + O_HP + (size_t)nh * 16384 + ((sub & 1) * 64 + dr) * 128 + (sub >> 1) * 32 + v4) = ov;
            __syncthreads();
        }
    }
}

__device__ __forceinline__ void phase_chunkO(const Params& p, LAS unsigned char* lds, int G) {
    const int tid = threadIdx.x, lane = tid & 63, wave = tid >> 6, d = tid & 127, sq = tid >> 7, fr = lane & 15, fq = lane >> 4;
    LAS bf16_t* QI = (LAS bf16_t*)lds;
    LAS bf16_t* QE = (LAS bf16_t*)(lds + 17408);
    LAS bf16_t* KI = (LAS bf16_t*)(lds + 34816);
    LAS bf16_t* vT = (LAS bf16_t*)(lds + 52224);
    LAS bf16_t* P = (LAS bf16_t*)(lds + 70656);
    LAS float* seg = (LAS float*)(lds + 79872);
    LAS float* red = (LAS float*)(lds + 81920);
    const float* LOGF = (const float*)(p.ws + OFF_LOGF); const bf16_t* KK = (const bf16_t*)(p.ws + OFF_KK); const bf16_t* V = (const bf16_t*)(p.ws + OFF_V);
    const bf16_t* Q = (const bf16_t*)(p.ws + OFF_Q); const bf16_t* ZA = (const bf16_t*)(p.ws + OFF_ZA); bf16_t* OAB = (bf16_t*)(p.ws + OFF_XB);
    const bf16_t* SC = (const bf16_t*)(p.ws + OFF_SC);
    for (int unit = blockIdx.x; unit < 1024; unit += G) {
        const int nh = unit >> 5, c = unit & 31, n = nh >> 2, h = nh & 3;
        const size_t row0 = (size_t)n * 2048 + c * 64;
        const float* lf = LOGF + (row0 + 16 * sq) * 512 + h * 128 + d;
        float g[16]; float run = 0.f;
#pragma unroll
        for (int i = 0; i < 16; ++i) { run += lf[(size_t)i * 512]; g[i] = run; }
        seg[sq * 128 + d] = run;
#pragma unroll
        for (int i = 0; i < 2; ++i) { const int id = tid + 512 * i, s = id >> 4, j = id & 15; const u32x4 w = *(const u32x4*)(V + (row0 + s) * 512 + h * 128 + 8 * j);
#pragma unroll
            for (int e = 0; e < 8; ++e) vT[(8 * j + e) * 72 + s] = (bf16_t)(w[e >> 1] >> (16 * (e & 1))); }
        __syncthreads();
        float off = 0.f;
#pragma unroll
        for (int q = 0; q < 4; ++q) { const float sv = seg[q * 128 + d]; if (q < sq) off += sv; }
        const float gmid = seg[d] + seg[128 + d];
        const bf16_t* qp = Q + (row0 + 16 * sq) * 512 + h * 128 + d; const bf16_t* kp = KK + (row0 + 16 * sq) * 512 + h * 128 + d;
#pragma unroll
        for (int i = 0; i < 16; ++i) {
            const int t = 16 * sq + i; const float gi = off + g[i], qv = bf2f(qp[(size_t)i * 512]), kv = bf2f(kp[(size_t)i * 512]);
            const float ei = __expf(fminf(fmaxf(gi - gmid, -80.f), 80.f));
            QI[t * 136 + d] = f2bf(qv * ei); QE[t * 136 + d] = f2bf(qv * __expf(gi)); KI[t * 136 + d] = f2bf(kv * rcpf_(ei));
        }
        __syncthreads();
        {
            const int sb = wave >> 1;
#pragma unroll
            for (int x = 0; x < 2; ++x) {
                const int tb = 2 * (wave & 1) + x;
                f32x4 acc = {0.f, 0.f, 0.f, 0.f};
                if (sb <= tb) {
#pragma unroll
                    for (int kd = 0; kd < 4; ++kd) { const bf16x8 a = *(const LAS bf16x8*)(KI + (sb * 16 + fr) * 136 + kd * 32 + fq * 8), b = *(const LAS bf16x8*)(QI + (tb * 16 + fr) * 136 + kd * 32 + fq * 8); acc = MFMA16(a, b, acc); }
                    const int t = tb * 16 + fr, s0 = sb * 16 + fq * 4;
#pragma unroll
                    for (int jj = 0; jj < 4; ++jj) if (s0 + jj > t) acc[jj] = 0.f;
                }
                u32x2 w; w.x = pk2(acc[0], acc[1]); w.y = pk2(acc[2], acc[3]);
                *(LAS u32x2*)(P + (tb * 16 + fr) * 72 + sb * 16 + fq * 4) = w;
            }
        }
        __syncthreads();
        f32x4 acc[4];
#pragma unroll
        for (int tt = 0; tt < 4; ++tt) acc[tt] = (f32x4){0.f, 0.f, 0.f, 0.f};
#pragma unroll
        for (int kd = 0; kd < 4; ++kd) {
            const bf16x8 a = *(const bf16x8*)(SC + (size_t)unit * 16384 + (wave * 16 + fr) * 128 + kd * 32 + fq * 8);
#pragma unroll
            for (int tt = 0; tt < 4; ++tt) { const bf16x8 b = *(const LAS bf16x8*)(QE + (tt * 16 + fr) * 136 + kd * 32 + fq * 8); acc[tt] = MFMA16(a, b, acc[tt]); }
        }
#pragma unroll
        for (int ks = 0; ks < 2; ++ks) {
            const bf16x8 a = *(const LAS bf16x8*)(vT + (wave * 16 + fr) * 72 + ks * 32 + fq * 8);
#pragma unroll
            for (int tt = 0; tt < 4; ++tt) { if (ks == 1 && tt < 2) continue; const bf16x8 b = *(const LAS bf16x8*)(P + (tt * 16 + fr) * 72 + ks * 32 + fq * 8); acc[tt] = MFMA16(a, b, acc[tt]); }
        }
#pragma unroll
        for (int tt = 0; tt < 4; ++tt) { float ss = (acc[tt][0] * acc[tt][0] + acc[tt][1] * acc[tt][1]) + (acc[tt][2] * acc[tt][2] + acc[tt][3] * acc[tt][3]); ss += __shfl_xor(ss, 16); ss += __shfl_xor(ss, 32); if (fq == 0) red[wave * 64 + tt * 16 + fr] = ss; }
        __syncthreads();
        const f32x4 gn = *(const f32x4*)(p.hgrn_norm_g + wave * 16 + fq * 4);
#pragma unroll
        for (int tt = 0; tt < 4; ++tt) {
            float tot = 0.f;
#pragma unroll
            for (int wv = 0; wv < 8; ++wv) tot += red[wv * 64 + tt * 16 + fr];
            const float r = rsqrtf(tot * (1.f / 128.f) + 1e-6f);
            const size_t row = row0 + tt * 16 + fr;
            const u32x2 za = *(const u32x2*)(ZA + row * 512 + h * 128 + wave * 16 + fq * 4);
            u32x2 w; w.x = pk2(acc[tt][0] * r * gn[0] * bflo(za.x), acc[tt][1] * r * gn[1] * bfhi(za.x)); w.y = pk2(acc[tt][2] * r * gn[2] * bflo(za.y), acc[tt][3] * r * gn[3] * bfhi(za.y));
            *(u32x2*)(OAB + row * 1024 + h * 128 + wave * 16 + fq * 4) = w;
        }
        __syncthreads();
    }
}

__device__ __forceinline__ void phase_final(const Params& p, int G) {
    const int tid = threadIdx.x, lane = tid & 63, wave = tid >> 6;
    const int gw = blockIdx.x * 8 + wave, NGW = G * 8;
    f32x4 gv[4];
#pragma unroll
    for (int j = 0; j < 4; ++j) gv[j] = ((const f32x4*)p.final_norm_g)[lane + 64 * j];
    for (int row = gw; row < MT; row += NGW) {
        f32x4* xr = (f32x4*)(p.out + (size_t)row * 1024) + lane;
        f32x4 v[4]; float s = 0.f;
#pragma unroll
        for (int j = 0; j < 4; ++j) { v[j] = xr[64 * j]; s += (v[j].x * v[j].x + v[j].y * v[j].y) + (v[j].z * v[j].z + v[j].w * v[j].w); }
        const float rs = rsqrtf(wave_sum(s) * (1.f / 1024.f) + 1e-6f);
#pragma unroll
        for (int j = 0; j < 4; ++j) xr[64 * j] = v[j] * rs * gv[j];
    }
}

__global__ void __launch_bounds__(512, 2) hymba_mega(Params p) {
    extern __shared__ __attribute__((aligned(16))) unsigned char smem[];
    LAS unsigned char* lds = (LAS unsigned char*)smem;
    const int G = gridDim.x;
    if (threadIdx.x < 4) ((LAS unsigned*)(lds + 131072))[threadIdx.x] = 0u;
    __syncthreads();
    XcdBarrier bar = xcd_barrier_post((unsigned*)(p.ws + OFF_BAR), (volatile LAS unsigned*)(lds + 131072));
    if (G > (1 << 20)) cg::this_grid().sync();
#define GRID_SYNC() xcd_barrier(bar)
#ifdef DIAG_POISON
    { u32x4 pz = {0xAAAAAAAAu, 0xAAAAAAAAu, 0xAAAAAAAAu, 0xAAAAAAAAu};
      for (size_t i = (size_t)blockIdx.x * 512 + threadIdx.x; i < OFF_BAR / 16; i += (size_t)G * 512) ((u32x4*)p.ws)[i] = pz;
      for (size_t i = (size_t)blockIdx.x * 512 + threadIdx.x; i < (O_CS + (size_t)128 * 30 * 512) / 4; i += (size_t)G * 512) ((u32x4*)p.out)[i] = pz;
      GRID_SYNC(); }
#endif
    if (PHASE_MASK & 1) phase0(p, lds, G);
    GRID_SYNC();
    if (PHASE_MASK & 2) {
        pg8::Gemm g{(const bf16_t*)(p.ws + OFF_XB), (const bf16_t*)(p.ws + OFF_WINT), MT, NIN, 1024};
        pg8::StaticOrder S; S.init(MT, NIN, G, (int)blockIdx.x);
        Epi1 E{(bf16_t*)(p.ws + OFF_Q), (bf16_t*)(p.ws + OFF_KK), (bf16_t*)(p.ws + OFF_V), (bf16_t*)(p.ws + OFF_ZA), (bf16_t*)(p.ws + OFF_U), (bf16_t*)(p.ws + OFF_ZB),
               (float*)(p.ws + OFF_LOGF), (const float*)(p.ws + OFF_LB), p.b_glu};
        pg8::gemm_phase<Epi1, pg8::StaticOrder>(lds, g, S, E, nullptr);
    }
    GRID_SYNC();
    if (PHASE_MASK & 4) { phase_chunkU(p, lds, G); phase_conv(p, lds, G);
#ifndef DIAG_ALT_HP
        phase_sample_hgrn(p, lds, G);
#endif
    }
    GRID_SYNC();
    if (PHASE_MASK & 8) phase_scan(p, lds, G);
    GRID_SYNC();
    if (PHASE_MASK & 16) phase_chunkO(p, lds, G);
    GRID_SYNC();
    if (PHASE_MASK & 32) {
        pg8::Gemm g{(const bf16_t*)(p.ws + OFF_XB), (const bf16_t*)(p.ws + OFF_WOUTT), MT, 1024, 1024};
        pg8::StaticOrder S; S.init(MT, 1024, G, (int)blockIdx.x);
        Epi2 E{p.x_prompt, p.x_sample, p.out};
        pg8::gemm_phase<Epi2, pg8::StaticOrder>(lds, g, S, E, nullptr);
    }
    GRID_SYNC();
    if (PHASE_MASK & 64) phase_final(p, G);
#ifdef DIAG_DUMP1
    { GRID_SYNC(); const size_t NE = (size_t)MT * 512; const float* LOGF = (const float*)(p.ws + OFF_LOGF); const bf16_t* KK = (const bf16_t*)(p.ws + DIAG_DUMP_B); const bf16_t* V = (const bf16_t*)(p.ws + DIAG_DUMP_C);
      for (size_t i = (size_t)blockIdx.x * 512 + threadIdx.x; i < NE; i += (size_t)G * 512) {
#if DIAG_DUMP1 == 1
        p.out[i] = LOGF[i];
#else
        p.out[i] = bf2f(((const bf16_t*)(p.ws + DIAG_DUMP_A))[i]);
#endif
        p.out[NE + i] = bf2f(KK[i]); p.out[2 * NE + i] = bf2f(V[i]); }
      for (size_t i = 3 * NE + (size_t)blockIdx.x * 512 + threadIdx.x; i < O_CS + (size_t)128 * 30 * 512; i += (size_t)G * 512) p.out[i] = 0.f; }
#endif
#ifdef DIAG_KEEP_LO
    { GRID_SYNC(); u32x4 z = {0u, 0u, 0u, 0u}; const size_t tot = (O_CS + (size_t)128 * 30 * 512) / 4, klo = (size_t)(DIAG_KEEP_LO) / 4, khi = (size_t)(DIAG_KEEP_HI) / 4;
      for (size_t i = (size_t)blockIdx.x * 512 + threadIdx.x; i < tot; i += (size_t)G * 512) if (i < klo || i >= khi) ((u32x4*)p.out)[i] = z; }
#endif
}

extern "C" void kernel_launch(void* const* d_in, const int* in_sizes, int n_in, void* d_out, int out_size, void* d_ws, size_t ws_size, hipStream_t stream) {
    static int grid = 0;
    if (grid == 0) {
        if (n_in != 15 || ws_size < WS_END) { fprintf(stderr, "kernel_launch: unexpected inputs (n_in %d, ws %zu)\n", n_in, ws_size); grid = -1; return; }
        int dev = 0, cus = 0, per_cu = 0;
        (void)hipGetDevice(&dev);
        (void)hipDeviceGetAttribute(&cus, hipDeviceAttributeMultiprocessorCount, dev);
        (void)hipFuncSetAttribute((const void*)hymba_mega, hipFuncAttributeMaxDynamicSharedMemorySize, LDS_BYTES);
        if (hipOccupancyMaxActiveBlocksPerMultiprocessor(&per_cu, (const void*)hymba_mega, 512, LDS_BYTES) != hipSuccess || per_cu < 1) { fprintf(stderr, "kernel_launch: occupancy query gave %d\n", per_cu); per_cu = 1; }
        (void)hipGetLastError();
        grid = cus;
    }
    if (grid < 0) return;
    if (hipMemsetAsync((char*)d_ws + OFF_BAR, 0, (size_t)XCD_BAR_WORDS * 4, stream) != hipSuccess) { fprintf(stderr, "kernel_launch: memset failed\n"); return; }
    Params p{};
    p.x_prompt = (const float*)d_in[0]; p.x_sample = (const float*)d_in[1]; p.state_hgrn = (const float*)d_in[2]; p.state_conv = (const float*)d_in[3];
    p.norm_in_g = (const float*)d_in[4]; p.w_in = (const float*)d_in[5]; p.lb_logits = (const float*)d_in[6]; p.hgrn_norm_g = (const float*)d_in[7];
    p.b_glu = (const float*)d_in[8]; p.conv_w = (const float*)d_in[9]; p.conv_b = (const float*)d_in[10]; p.ln_g = (const float*)d_in[11]; p.ln_b = (const float*)d_in[12];
    p.w_out = (const float*)d_in[13]; p.final_norm_g = (const float*)d_in[14];
    p.out = (float*)d_out; p.ws = (unsigned char*)d_ws;
    void* args[] = {&p};
    hipError_t e = hipLaunchCooperativeKernel((const void*)hymba_mega, dim3(grid), dim3(512), args, LDS_BYTES, stream);
    if (e != hipSuccess) fprintf(stderr, "cooperative launch failed: %s (grid %d)\n", hipGetErrorString(e), grid);
}
```
